# Optimizing an MI355X kernel written in HIP

```python
import math
import jax, jax.numpy as jnp
from jax import lax
import numpy as np

D_MODEL = 1024
BATCH = 4
SEQ = 4096
DEPTH = 4

GRID_W = 64
N_Q_HEADS = 8
N_KV_HEADS = 2
HEAD_DIM = 64
Q_BLOCK = 128
ROPE_THETA = 10000.0
ATTN_WIDTH = N_Q_HEADS * HEAD_DIM
KV_WIDTH = N_KV_HEADS * HEAD_DIM
SGU_GROUPS = 8
SGU_WIDTH = 512
SGU_GROUP_DIM = SGU_WIDTH // SGU_GROUPS
SGU_CHUNK = 128
Q_END = ATTN_WIDTH
K_END = Q_END + KV_WIDTH
V_END = K_END + KV_WIDTH
Z_END = V_END + 2 * SGU_WIDTH
GA_END = Z_END + D_MODEL
IN_COLS = GA_END + D_MODEL
N_EXPERTS = 64
TOP_K = 8
N_GROUPS = 8
TOPK_GROUPS = 4
EXPERT_FF = 256
SHARED_FF = 256
ROUTED_SCALE = 2.5
MOE_BLOCK = 128
ALPHA = (2 * DEPTH) ** 0.25
BETA = (8 * DEPTH) ** -0.25

kernel_name = 'hybrid_gqa_sgu_moe_deepnorm_encoder'


def layer_norm(x, g, b, eps=1e-5):
    xf = x.astype(jnp.float32)
    mu = jnp.mean(xf, -1, keepdims=True)
    var = jnp.mean(jnp.square(xf - mu), -1, keepdims=True)
    return ((xf - mu) * lax.rsqrt(var + eps)).astype(x.dtype) * g + b


def rms_norm(x, g, eps=1e-6):
    xf = x.astype(jnp.float32)
    return (xf * lax.rsqrt(jnp.mean(jnp.square(xf), -1, keepdims=True) + eps)).astype(x.dtype) * g


def axial_rope_tables(seq_len, rows):
    t = jnp.arange(seq_len)
    row = (t // GRID_W - rows // 2).astype(jnp.float32)
    col = (t % GRID_W - GRID_W // 2).astype(jnp.float32)
    n_pairs = HEAD_DIM // 4
    inv_freq = ROPE_THETA ** (-jnp.arange(n_pairs, dtype=jnp.float32) / n_pairs)
    ang = jnp.concatenate([row[:, None] * inv_freq, col[:, None] * inv_freq], -1)
    return jnp.cos(ang), jnp.sin(ang)


def apply_rope(x, cos, sin):
    xf = x.astype(jnp.float32).reshape(*x.shape[:-1], HEAD_DIM // 2, 2)
    x0, x1 = xf[..., 0], xf[..., 1]
    c = cos[None, :, None, :]
    s = sin[None, :, None, :]
    out = jnp.stack([x0 * c - x1 * s, x0 * s + x1 * c], -1)
    return out.reshape(x.shape).astype(x.dtype)


def attention_branch(q, k, v, q_scale, k_scale, cos, sin):
    B, S = q.shape[:2]
    grp = N_Q_HEADS // N_KV_HEADS
    q = apply_rope(rms_norm(q, q_scale), cos, sin)
    k = apply_rope(rms_norm(k, k_scale), cos, sin)
    nqb = S // Q_BLOCK
    qb = q.reshape(B, nqb, Q_BLOCK, N_KV_HEADS, grp, HEAD_DIM).transpose(1, 0, 3, 4, 2, 5)
    kt = k.transpose(0, 2, 1, 3)
    vt = v.transpose(0, 2, 1, 3)
    scale = HEAD_DIM ** -0.5

    def attend(q_blk):
        s = jnp.einsum('bkgqd,bksd->bkgqs', q_blk, kt).astype(jnp.float32) * scale
        p = jax.nn.softmax(s, axis=-1).astype(vt.dtype)
        return jnp.einsum('bkgqs,bksd->bkgqd', p, vt)

    o = lax.map(attend, qb)
    return o.transpose(1, 0, 4, 2, 3, 5).reshape(B, S, ATTN_WIDTH)


def spatial_gating_branch(z, ln_g, ln_b, w_s, b_s):
    B, S, _ = z.shape
    z = jax.nn.gelu(z, approximate=False)
    u, v = z[..., :SGU_WIDTH], z[..., SGU_WIDTH:]
    v = layer_norm(v, ln_g, ln_b)
    vc = v.reshape(B, S // SGU_CHUNK, SGU_CHUNK, SGU_GROUPS, SGU_GROUP_DIM)
    sv = jnp.einsum('gij,bnjgd->bnigd', w_s, vc) + b_s.T[:, :, None]
    return u * sv.reshape(B, S, SGU_WIDTH)


def token_mixer(h, w_in, q_scale, k_scale, sgu_ln_g, sgu_ln_b, w_s, b_s, w_branch_a, w_branch_b, w_out, cos, sin):
    B, S, _ = h.shape
    p = h @ w_in
    q = p[..., :Q_END].reshape(B, S, N_Q_HEADS, HEAD_DIM)
    k = p[..., Q_END:K_END].reshape(B, S, N_KV_HEADS, HEAD_DIM)
    v = p[..., K_END:V_END].reshape(B, S, N_KV_HEADS, HEAD_DIM)
    z = p[..., V_END:Z_END]
    gate_a = p[..., Z_END:GA_END]
    gate_b = p[..., GA_END:]
    o_a = attention_branch(q, k, v, q_scale, k_scale, cos, sin)
    o_b = spatial_gating_branch(z, sgu_ln_g, sgu_ln_b, w_s, b_s)
    y = jax.nn.sigmoid(gate_a) * (o_a @ w_branch_a) + jax.nn.sigmoid(gate_b) * (o_b @ w_branch_b)
    return y @ w_out


def moe_ffn(h, router_w, router_bias, w_gate, w_up, w_down, ws_gate, ws_up, ws_down):
    B, S, D = h.shape
    T = B * S
    xt = h.reshape(T, D)
    scores = jax.nn.sigmoid((xt @ router_w).astype(jnp.float32))
    sel = scores + router_bias.astype(jnp.float32)
    per_group = N_EXPERTS // N_GROUPS
    group_score = lax.top_k(sel.reshape(T, N_GROUPS, per_group), 2)[0].sum(-1)
    _, gidx = lax.top_k(group_score, TOPK_GROUPS)
    gmask = jnp.any(gidx[..., None] == jnp.arange(N_GROUPS), axis=-2)
    emask = jnp.repeat(gmask, per_group, axis=-1)
    _, eidx = lax.top_k(jnp.where(emask, sel, -jnp.inf), TOP_K)
    wts = jnp.take_along_axis(scores, eidx, -1)
    wts = wts / jnp.sum(wts, -1, keepdims=True) * ROUTED_SCALE
    A = T * TOP_K
    e_flat = eidx.reshape(A)
    t_flat = jnp.repeat(jnp.arange(T, dtype=jnp.int32), TOP_K)
    w_flat = wts.reshape(A)
    order = jnp.argsort(e_flat)
    e_s, t_s, w_s = e_flat[order], t_flat[order], w_flat[order]
    counts = jnp.bincount(e_flat, length=N_EXPERTS)
    starts = jnp.cumsum(counts) - counts
    padded = (counts + MOE_BLOCK - 1) // MOE_BLOCK * MOE_BLOCK
    pends = jnp.cumsum(padded)
    pstarts = pends - padded
    dest = pstarts[e_s] + (jnp.arange(A) - starts[e_s])
    n_blocks = A // MOE_BLOCK + N_EXPERTS
    P = n_blocks * MOE_BLOCK
    tok_buf = jnp.full((P,), T, jnp.int32).at[dest].set(t_s.astype(jnp.int32))
    w_buf = jnp.zeros((P,), xt.dtype).at[dest].set(w_s.astype(xt.dtype))
    blk_expert = jnp.minimum(jnp.searchsorted(pends, jnp.arange(n_blocks) * MOE_BLOCK, side='right'), N_EXPERTS - 1)
    x_pad = jnp.concatenate([xt, jnp.zeros((1, D), xt.dtype)], 0)

    def run_block(args):
        e, toks, ws = args
        xb = x_pad[toks]
        hb = jax.nn.silu(xb @ w_gate[e]) * (xb @ w_up[e])
        return (hb @ w_down[e]) * ws[:, None]

    yb = lax.map(run_block, (blk_expert, tok_buf.reshape(n_blocks, MOE_BLOCK), w_buf.reshape(n_blocks, MOE_BLOCK)))
    routed = jax.ops.segment_sum(yb.reshape(P, D), tok_buf, num_segments=T + 1)[:T]
    shared = (jax.nn.silu(xt @ ws_gate) * (xt @ ws_up)) @ ws_down
    return (routed + shared).reshape(B, S, D)


def setup_inputs(seed: int = 0) -> dict:
    key = jax.random.key(seed)
    ks = jax.random.split(key, 26)
    L, D, E = DEPTH, D_MODEL, N_EXPERTS
    f32 = jnp.float32

    def nrm(k, shape, s):
        return jax.random.normal(k, shape, f32) * s

    def gain(k, shape):
        return 1.0 + 0.02 * jax.random.normal(k, shape, f32)

    w_in = nrm(ks[4], (L, D, IN_COLS), D ** -0.5)
    w_in = w_in.at[:, :, K_END:V_END].multiply(BETA)
    return {
        'x': nrm(ks[0], (BATCH, SEQ, D), 1.0),
        'c': nrm(ks[1], (BATCH, D), 1.0),
        'w_ada': nrm(ks[2], (L, D, 6 * D), 0.5 * D ** -0.5),
        'b_ada': nrm(ks[3], (L, 6 * D), 0.02),
        'w_in': w_in,
        'q_scale': gain(ks[5], (L, HEAD_DIM)),
        'k_scale': gain(ks[6], (L, HEAD_DIM)),
        'sgu_ln_g': gain(ks[7], (L, SGU_WIDTH)),
        'sgu_ln_b': nrm(ks[8], (L, SGU_WIDTH), 0.02),
        'w_spatial': nrm(ks[9], (L, SGU_GROUPS, SGU_CHUNK, SGU_CHUNK), SGU_CHUNK ** -0.5),
        'b_spatial': nrm(ks[10], (L, SGU_GROUPS, SGU_CHUNK), 0.02),
        'w_branch_a': nrm(ks[11], (L, ATTN_WIDTH, D), ATTN_WIDTH ** -0.5),
        'w_branch_b': nrm(ks[12], (L, SGU_WIDTH, D), SGU_WIDTH ** -0.5),
        'w_out': nrm(ks[13], (L, D, D), BETA * D ** -0.5),
        'ln1_g': gain(ks[14], (L, D)),
        'ln1_b': nrm(ks[15], (L, D), 0.02),
        'router_w': nrm(ks[16], (L, D, E), D ** -0.5),
        'router_bias': nrm(ks[17], (L, E), 0.01),
        'w_gate': nrm(ks[18], (L, E, D, EXPERT_FF), D ** -0.5),
        'w_up': nrm(ks[19], (L, E, D, EXPERT_FF), D ** -0.5),
        'w_down': nrm(ks[20], (L, E, EXPERT_FF, D), BETA * EXPERT_FF ** -0.5),
        'ws_gate': nrm(ks[21], (L, D, SHARED_FF), D ** -0.5),
        'ws_up': nrm(ks[22], (L, D, SHARED_FF), D ** -0.5),
        'ws_down': nrm(ks[23], (L, SHARED_FF, D), BETA * SHARED_FF ** -0.5),
        'ln2_g': gain(ks[24], (L, D)),
        'ln2_b': nrm(ks[25], (L, D), 0.02),
    }


def reference(x, c, w_ada, b_ada, w_in, q_scale, k_scale, sgu_ln_g, sgu_ln_b, w_spatial, b_spatial,
              w_branch_a, w_branch_b, w_out, ln1_g, ln1_b, router_w, router_bias, w_gate, w_up, w_down,
              ws_gate, ws_up, ws_down, ln2_g, ln2_b):
    B, S, D = x.shape
    rows = S // GRID_W
    cos, sin = axial_rope_tables(S, rows)
    cond = jax.nn.silu(c)
    for l in range(DEPTH):
        mod = cond @ w_ada[l] + b_ada[l]
        shift1, scale1, gate1, shift2, scale2, gate2 = jnp.split(mod[:, None, :], 6, axis=-1)
        h = x * (1 + scale1) + shift1
        y = token_mixer(h, w_in[l], q_scale[l], k_scale[l], sgu_ln_g[l], sgu_ln_b[l], w_spatial[l], b_spatial[l],
                        w_branch_a[l], w_branch_b[l], w_out[l], cos, sin)
        x = layer_norm(ALPHA * x + gate1 * y, ln1_g[l], ln1_b[l])
        h = x * (1 + scale2) + shift2
        y = moe_ffn(h, router_w[l], router_bias[l], w_gate[l], w_up[l], w_down[l], ws_gate[l], ws_up[l], ws_down[l])
        x = layer_norm(ALPHA * x + gate2 * y, ln2_g[l], ln2_b[l])
    return x
```

```cpp
#include <hip/hip_runtime.h>
#include <cstdio>
#include <cstdint>
#include <cmath>

typedef unsigned short bf16;
typedef short bf16x8 __attribute__((ext_vector_type(8)));
typedef float f32x4 __attribute__((ext_vector_type(4)));

constexpr int L_ = 4, D_ = 1024, B_ = 4, S_ = 4096, T_ = B_ * S_;
constexpr int NQH = 8, NKVH = 2, HD = 64, AW = 512, KVW = 128, SW = 512;
constexpr int INC = 3840, NE = 64, TOPK = 8, EFF = 256;
constexpr int Q_END = 512, K_END = 640, V_END = 768, Z_END = 1792, GA_END = 2816;
constexpr float ALPHA = 1.681792830507429f;
constexpr float C2 = 0.125f * 1.4426950408889634f;
constexpr int NEX = NE + 1;
constexpr int NSLOT = TOPK + 1;

constexpr size_t MiB = 1ull << 20;
constexpr size_t WO_IN = 0;
constexpr size_t WO_A = WO_IN + (size_t)INC * D_;
constexpr size_t WO_B = WO_A + (size_t)D_ * AW;
constexpr size_t WO_OUT = WO_B + (size_t)D_ * SW;
constexpr size_t WO_R = WO_OUT + (size_t)D_ * D_;
constexpr size_t WO_GU = WO_R + (size_t)NE * D_;
constexpr size_t WO_DN = WO_GU + (size_t)NEX * 512 * D_;
constexpr size_t WO_SP = WO_DN + (size_t)NEX * D_ * EFF;
constexpr size_t WL_ELEMS = WO_SP + (size_t)8 * 128 * 128;
constexpr size_t WL_BYTES = ((WL_ELEMS * 2 + 4095) / 4096) * 4096;

constexpr size_t WS_CTL = 0;
constexpr size_t CTL_BYTES = 1 * MiB;
constexpr size_t WS_MOD = 1 * MiB;
constexpr size_t WS_ROPE = 2 * MiB;
constexpr size_t WS_LIST = 3 * MiB;
constexpr size_t WS_STATS = 15 * MiB;
constexpr size_t WS_W = 16 * MiB;
constexpr size_t WS_X = WS_W + 4 * WL_BYTES;
constexpr size_t WS_X1 = WS_X + (size_t)T_ * D_ * 4;
constexpr size_t WS_HA = WS_X1 + (size_t)T_ * D_ * 4;
constexpr size_t HB_ROWS = (size_t)T_ * TOPK + T_ + NEX * 256;
constexpr size_t WS_HB = WS_HA + (size_t)T_ * D_ * 2;
constexpr size_t WS_OV = ((WS_HB + HB_ROWS * EFF * 2 + 4095) / 4096) * 4096;
constexpr size_t OV_Q = 0;
constexpr size_t OV_K = OV_Q + (size_t)T_ * AW * 2;
constexpr size_t OV_V = OV_K + (size_t)T_ * KVW * 2;
constexpr size_t OV_U = OV_V + (size_t)T_ * KVW * 2;
constexpr size_t OV_VG = OV_U + (size_t)T_ * SW * 2;
constexpr size_t OV_GA = OV_VG + (size_t)T_ * SW * 2;
constexpr size_t OV_GB = OV_GA + (size_t)T_ * D_ * 2;
constexpr size_t OV_OA = OV_GB + (size_t)T_ * D_ * 2;
constexpr size_t OV_OB = OV_OA + (size_t)T_ * AW * 2;
constexpr size_t OV_YB = OV_OB + (size_t)T_ * SW * 2;
constexpr size_t OV_TMP = OV_YB + (size_t)T_ * D_ * 2;
constexpr size_t OV_PQK = OV_TMP + (size_t)T_ * D_ * 4;
constexpr size_t OV_LOG = OV_PQK + (size_t)T_ * 640 * 4;
constexpr size_t OV_END_MIX = OV_LOG + (size_t)T_ * 64 * 4;
constexpr size_t OV_Y = 0;
constexpr size_t OV_END_Y = OV_Y + (size_t)T_ * NSLOT * D_ * 2;
constexpr size_t WS_END = WS_OV + (OV_END_MIX > OV_END_Y ? OV_END_MIX : OV_END_Y);

constexpr int CW_CNT = 1024;
constexpr int CW_BASE = 2048;

__device__ __forceinline__ float bf2f(bf16 v) { return __uint_as_float((unsigned)v << 16); }
__device__ __forceinline__ bf16 f2bf(float f) { unsigned u = __float_as_uint(f); return (bf16)((u + 0x7fffu + ((u >> 16) & 1u)) >> 16); }
__device__ __forceinline__ float sigmoidf_(float x) { return 1.f / (1.f + __expf(-x)); }
__device__ __forceinline__ float gelu_exact(float x) { return 0.5f * x * (1.f + erff(x * 0.70710678118654752f)); }
__device__ __forceinline__ float wave_sum(float v) {
#pragma unroll
    for (int o = 1; o < 64; o <<= 1) v += __shfl_xor(v, o);
    return v;
}

__global__ void k_mod(const float* __restrict__ c, const float* __restrict__ w_ada, const float* __restrict__ b_ada, float* __restrict__ mod) {
    const int idx = blockIdx.x * blockDim.x + threadIdx.x;
    if (idx >= L_ * B_ * 6 * D_) return;
    const int n = idx % (6 * D_), b = (idx / (6 * D_)) % B_, l = idx / (6 * D_ * B_);
    const float* w = w_ada + (size_t)l * D_ * 6 * D_ + n;
    const float* cb = c + b * D_;
    float acc = 0.f;
    for (int k = 0; k < D_; ++k) { const float cv = cb[k]; acc += (cv * sigmoidf_(cv)) * w[(size_t)k * 6 * D_]; }
    mod[idx] = acc + b_ada[l * 6 * D_ + n];
}
__global__ void k_rope(float* __restrict__ cs) {
    const int idx = blockIdx.x * blockDim.x + threadIdx.x;
    if (idx >= S_ * 32) return;
    const int t = idx / 32, i = idx % 32;
    const float pos = (i < 16) ? (float)(t / 64 - 32) : (float)(t % 64 - 32);
    const float inv = powf(10000.f, -(float)(i % 16) / 16.f);
    const float a = pos * inv;
    cs[idx] = cosf(a); cs[S_ * 32 + idx] = sinf(a);
}
__global__ void k_transpose(const float* __restrict__ src, bf16* __restrict__ dst, int K, int N, int mode, size_t sstride, size_t dstride) {
    __shared__ float t[32][33];
    src += blockIdx.z * sstride; dst += blockIdx.z * dstride;
    const int n0 = blockIdx.x * 32, k0 = blockIdx.y * 32, tx = threadIdx.x, ty = threadIdx.y;
#pragma unroll
    for (int i = 0; i < 4; ++i) t[ty + 8 * i][tx] = src[(size_t)(k0 + ty + 8 * i) * N + n0 + tx];
    __syncthreads();
#pragma unroll
    for (int i = 0; i < 4; ++i) { const int n = n0 + ty + 8 * i; int row = n; if (mode) row = 256 * (n / 128) + (n % 128) + (mode == 2 ? 128 : 0);
        dst[(size_t)row * K + k0 + tx] = f2bf(t[tx][ty + 8 * i]); }
}
__global__ void k_cvt(const float* __restrict__ src, bf16* __restrict__ dst, int n) {
    const int i = blockIdx.x * blockDim.x + threadIdx.x; if (i < n) dst[i] = f2bf(src[i]);
}
__global__ void k_modulate(const float* __restrict__ x, const float* __restrict__ mod, bf16* __restrict__ h) {
    const size_t idx = (size_t)blockIdx.x * blockDim.x + threadIdx.x;
    if (idx >= (size_t)T_ * D_) return;
    const int d = idx % D_, b = idx / ((size_t)S_ * D_);
    const float* m = mod + (size_t)b * 6 * D_;
    h[idx] = f2bf(x[idx] * (1.f + m[D_ + d]) + m[d]);
}

struct GCtx { const bf16* B; int M, K; int z; const int* tok; const float* w; const int* dst; size_t hbase; };
template <class Epi, bool DUAL>
__global__ __launch_bounds__(256) void k_gemm(Epi epi) {
    GCtx ctx; ctx.z = blockIdx.z;
    if (!epi.setup(ctx)) return;
    const int wave = threadIdx.x >> 6, lane = threadIdx.x & 63, fr = lane & 15, fq = lane >> 4;
    const int row0 = blockIdx.y * 128 + wave * 32;
    if (row0 >= ctx.M) return;
    const int col0 = blockIdx.x * 64;
    const bf16* ap[2]; const bf16* bp[4]; const bf16* bp2[4];
#pragma unroll
    for (int i = 0; i < 2; ++i) { int r = row0 + 16 * i + fr; if (r >= ctx.M) r = ctx.M - 1; ap[i] = epi.arow(ctx, r) + 8 * fq; }
#pragma unroll
    for (int j = 0; j < 4; ++j) { bp[j] = ctx.B + (size_t)epi.brow(col0 + 16 * j + fr) * ctx.K + 8 * fq; bp2[j] = DUAL ? ctx.B + (size_t)epi.brow2(col0 + 16 * j + fr) * ctx.K + 8 * fq : bp[j]; }
    f32x4 acc[2][4], acc2[2][4];
#pragma unroll
    for (int i = 0; i < 2; ++i)
#pragma unroll
        for (int j = 0; j < 4; ++j) { acc[i][j] = (f32x4){0.f, 0.f, 0.f, 0.f}; acc2[i][j] = (f32x4){0.f, 0.f, 0.f, 0.f}; }
    for (int k0 = 0; k0 < ctx.K; k0 += 32) {
        bf16x8 a[2], b[4], b2[4];
#pragma unroll
        for (int i = 0; i < 2; ++i) a[i] = *(const bf16x8*)(ap[i] + k0);
#pragma unroll
        for (int j = 0; j < 4; ++j) { b[j] = *(const bf16x8*)(bp[j] + k0); if (DUAL) b2[j] = *(const bf16x8*)(bp2[j] + k0); }
#pragma unroll
        for (int i = 0; i < 2; ++i)
#pragma unroll
            for (int j = 0; j < 4; ++j) { acc[i][j] = __builtin_amdgcn_mfma_f32_16x16x32_bf16(a[i], b[j], acc[i][j], 0, 0, 0);
                if (DUAL) acc2[i][j] = __builtin_amdgcn_mfma_f32_16x16x32_bf16(a[i], b2[j], acc2[i][j], 0, 0, 0); }
    }
#pragma unroll
    for (int i = 0; i < 2; ++i)
#pragma unroll
        for (int j = 0; j < 4; ++j)
#pragma unroll
            for (int jj = 0; jj < 4; ++jj) { const int r = row0 + 16 * i + 4 * fq + jj, c = col0 + 16 * j + fr;
                if (r < ctx.M) epi.store(ctx, r, c, acc[i][j][jj], acc2[i][j][jj]); }
}

struct EpiIn {
    const bf16* A; const bf16* Bw; float* pqk; bf16 *V, *U, *VG, *GA, *GB;
    __device__ bool setup(GCtx& c) const { c.B = Bw; c.M = T_; c.K = D_; return true; }
    __device__ const bf16* arow(const GCtx&, int r) const { return A + (size_t)r * D_; }
    __device__ int brow(int n) const { return n; }
    __device__ int brow2(int n) const { return n; }
    __device__ void store(const GCtx&, int r, int c, float v, float) const {
        if (c < K_END) pqk[(size_t)r * 640 + c] = v;
        else if (c < V_END) V[(size_t)r * KVW + (c - K_END)] = f2bf(v);
        else if (c < V_END + SW) U[(size_t)r * SW + (c - V_END)] = f2bf(gelu_exact(v));
        else if (c < Z_END) VG[(size_t)r * SW + (c - V_END - SW)] = f2bf(gelu_exact(v));
        else if (c < GA_END) GA[(size_t)r * D_ + (c - Z_END)] = f2bf(sigmoidf_(v));
        else GB[(size_t)r * D_ + (c - GA_END)] = f2bf(sigmoidf_(v));
    }
};
struct EpiBrA {
    const bf16* A; const bf16* Bw; const bf16* G; float* tmp;
    __device__ bool setup(GCtx& c) const { c.B = Bw; c.M = T_; c.K = AW; return true; }
    __device__ const bf16* arow(const GCtx&, int r) const { return A + (size_t)r * AW; }
    __device__ int brow(int n) const { return n; }
    __device__ int brow2(int n) const { return n; }
    __device__ void store(const GCtx&, int r, int c, float v, float) const { tmp[(size_t)r * D_ + c] = bf2f(G[(size_t)r * D_ + c]) * v; }
};
struct EpiBrB {
    const bf16* A; const bf16* Bw; const bf16* G; const float* tmp; bf16* Y;
    __device__ bool setup(GCtx& c) const { c.B = Bw; c.M = T_; c.K = SW; return true; }
    __device__ const bf16* arow(const GCtx&, int r) const { return A + (size_t)r * SW; }
    __device__ int brow(int n) const { return n; }
    __device__ int brow2(int n) const { return n; }
    __device__ void store(const GCtx&, int r, int c, float v, float) const { Y[(size_t)r * D_ + c] = f2bf(tmp[(size_t)r * D_ + c] + bf2f(G[(size_t)r * D_ + c]) * v); }
};
struct EpiF32 {
    const bf16* A; const bf16* Bw; float* out; int K, ldc;
    __device__ bool setup(GCtx& c) const { c.B = Bw; c.M = T_; c.K = K; return true; }
    __device__ const bf16* arow(const GCtx&, int r) const { return A + (size_t)r * K; }
    __device__ int brow(int n) const { return n; }
    __device__ int brow2(int n) const { return n; }
    __device__ void store(const GCtx&, int r, int c, float v, float) const { out[(size_t)r * ldc + c] = v; }
};
struct EpiGU {
    const bf16* H2; const bf16* Wgu; bf16* HB; const unsigned* cnt; const unsigned* base; const int* ltok;
    __device__ bool setup(GCtx& c) const { const int e = c.z; c.B = Wgu + (size_t)e * 512 * D_; c.K = D_; c.M = (e < NE) ? (int)cnt[e] : T_; c.tok = ltok + (size_t)e * T_; c.hbase = base[e]; return c.M > 0; }
    __device__ const bf16* arow(const GCtx& c, int r) const { const int t = (c.z < NE) ? c.tok[r] : r; return H2 + (size_t)t * D_; }
    __device__ int brow(int f) const { return 256 * (f / 128) + (f % 128); }
    __device__ int brow2(int f) const { return 256 * (f / 128) + (f % 128) + 128; }
    __device__ void store(const GCtx& c, int r, int f, float g, float u) const { HB[(c.hbase + r) * EFF + f] = f2bf(g * sigmoidf_(g) * u); }
};
struct EpiDN {
    const bf16* HB; const bf16* Wd; bf16* Y; const unsigned* cnt; const unsigned* base; const float* lw; const int* ldst;
    __device__ bool setup(GCtx& c) const { const int e = c.z; c.B = Wd + (size_t)e * D_ * EFF; c.K = EFF; c.M = (e < NE) ? (int)cnt[e] : T_; c.w = lw + (size_t)e * T_; c.dst = ldst + (size_t)e * T_; c.hbase = base[e]; return c.M > 0; }
    __device__ const bf16* arow(const GCtx& c, int r) const { return HB + (c.hbase + r) * EFF; }
    __device__ int brow(int n) const { return n; }
    __device__ int brow2(int n) const { return n; }
    __device__ void store(const GCtx& c, int r, int col, float v, float) const {
        float w = 1.f; size_t d = (size_t)r * NSLOT + TOPK; if (c.z < NE) { w = c.w[r]; d = (size_t)c.dst[r]; }
        Y[d * D_ + col] = f2bf(w * v); }
};

__global__ __launch_bounds__(256) void k_qknorm(const float* __restrict__ pqk, const float* __restrict__ qs, const float* __restrict__ ks, const float* __restrict__ cs, bf16* __restrict__ Q, bf16* __restrict__ Kb) {
    const int idx = blockIdx.x * blockDim.x + threadIdx.x;
    if (idx >= T_ * 10) return;
    const int r = idx / 10, h = idx % 10, t = r % S_;
    const float* p = pqk + (size_t)r * 640 + h * 64;
    float v[64]; float ss = 0.f;
#pragma unroll
    for (int i = 0; i < 64; ++i) { v[i] = p[i]; ss += v[i] * v[i]; }
    const float rs = rsqrtf(ss * (1.f / 64.f) + 1e-6f);
    const float* g = (h < 8) ? qs : ks;
    const float* co = cs + (size_t)t * 32; const float* si = cs + (size_t)S_ * 32 + (size_t)t * 32;
    bf16* o = (h < 8) ? (Q + (size_t)r * AW + h * 64) : (Kb + (size_t)r * KVW + (h - 8) * 64);
    const float sc = (h < 8) ? C2 : 1.f;
#pragma unroll
    for (int i = 0; i < 32; ++i) { const float x0 = v[2 * i] * rs * g[2 * i], x1 = v[2 * i + 1] * rs * g[2 * i + 1];
        o[2 * i] = f2bf((x0 * co[i] - x1 * si[i]) * sc); o[2 * i + 1] = f2bf((x0 * si[i] + x1 * co[i]) * sc); }
}

__global__ __launch_bounds__(256) void k_attn(const bf16* __restrict__ Q, const bf16* __restrict__ Kb, const bf16* __restrict__ Vb, bf16* __restrict__ O) {
    __shared__ float sk[64][64], sv[64][64];
    const int qb = blockIdx.x, h = blockIdx.y, b = blockIdx.z, kvh = h / 4;
    const int t = qb * 256 + threadIdx.x;
    const size_t row = (size_t)b * S_ + t;
    float q[64], o[64];
#pragma unroll
    for (int i = 0; i < 64; ++i) { q[i] = bf2f(Q[row * AW + h * 64 + i]); o[i] = 0.f; }
    float m = -1e30f, l = 0.f;
    for (int k0 = 0; k0 < S_; k0 += 64) {
        __syncthreads();
        for (int e = threadIdx.x; e < 64 * 64; e += 256) { const int kr = e / 64, d = e % 64; const size_t kr_g = (size_t)b * S_ + k0 + kr;
            sk[kr][d] = bf2f(Kb[kr_g * KVW + kvh * 64 + d]); sv[kr][d] = bf2f(Vb[kr_g * KVW + kvh * 64 + d]); }
        __syncthreads();
        for (int kk = 0; kk < 64; ++kk) {
            float s = 0.f;
#pragma unroll
            for (int i = 0; i < 64; ++i) s += q[i] * sk[kk][i];
            if (s > m) { const float f = exp2f(m - s); l *= f;
#pragma unroll
                for (int i = 0; i < 64; ++i) o[i] *= f;
                m = s; }
            const float p = exp2f(s - m); l += p;
#pragma unroll
            for (int i = 0; i < 64; ++i) o[i] += p * sv[kk][i];
        }
    }
    const float il = 1.f / l;
#pragma unroll
    for (int i = 0; i < 64; ++i) O[row * AW + h * 64 + i] = f2bf(o[i] * il);
}

__global__ void k_vstats(const bf16* __restrict__ VG, float* __restrict__ st) {
    const int row = blockIdx.x * 4 + (threadIdx.x >> 6), lane = threadIdx.x & 63;
    float v[8]; float s = 0.f;
#pragma unroll
    for (int i = 0; i < 8; ++i) { v[i] = bf2f(VG[(size_t)row * SW + lane + 64 * i]); s += v[i]; }
    const float mean = wave_sum(s) * (1.f / SW); float q = 0.f;
#pragma unroll
    for (int i = 0; i < 8; ++i) { const float d = v[i] - mean; q += d * d; }
    const float var = wave_sum(q) * (1.f / SW);
    if (lane == 0) { st[2 * row] = mean; st[2 * row + 1] = rsqrtf(var + 1e-5f); }
}
__global__ void k_sgu(const bf16* __restrict__ U, const bf16* __restrict__ VG, const float* __restrict__ st, const float* __restrict__ lg, const float* __restrict__ lb,
                      const float* __restrict__ wsp, const float* __restrict__ bsp, bf16* __restrict__ OB) {
    const int t = blockIdx.x, c = threadIdx.x, g = c / 64, n = t / 128, i = t % 128;
    const float* w = wsp + ((size_t)g * 128 + i) * 128;
    const float gg = lg[c], bb = lb[c];
    float acc = 0.f;
    for (int j = 0; j < 128; ++j) { const size_t r = (size_t)n * 128 + j; const float vn = (bf2f(VG[r * SW + c]) - st[2 * r]) * st[2 * r + 1] * gg + bb; acc += w[j] * vn; }
    acc += bsp[g * 128 + i];
    OB[(size_t)t * SW + c] = f2bf(bf2f(U[(size_t)t * SW + c]) * acc);
}

__global__ __launch_bounds__(256) void k_ln1(const float* __restrict__ xin, const float* __restrict__ z, const float* __restrict__ mod, const float* __restrict__ g, const float* __restrict__ bta, float* __restrict__ x1, bf16* __restrict__ h2) {
    const int row = blockIdx.x * 4 + (threadIdx.x >> 6), lane = threadIdx.x & 63, b = row / S_;
    const float* m = mod + (size_t)b * 6 * D_;
    float v[16]; float s = 0.f;
#pragma unroll
    for (int i = 0; i < 16; ++i) { const int d = lane + 64 * i; v[i] = ALPHA * xin[(size_t)row * D_ + d] + m[2 * D_ + d] * z[(size_t)row * D_ + d]; s += v[i]; }
    const float mean = wave_sum(s) * (1.f / D_); float q = 0.f;
#pragma unroll
    for (int i = 0; i < 16; ++i) { v[i] -= mean; q += v[i] * v[i]; }
    const float rstd = rsqrtf(wave_sum(q) * (1.f / D_) + 1e-5f);
#pragma unroll
    for (int i = 0; i < 16; ++i) { const int d = lane + 64 * i; const float o = v[i] * rstd * g[d] + bta[d]; x1[(size_t)row * D_ + d] = o;
        h2[(size_t)row * D_ + d] = f2bf(o * (1.f + m[4 * D_ + d]) + m[3 * D_ + d]); }
}
__global__ __launch_bounds__(256) void k_ln2(const float* __restrict__ x1, const bf16* __restrict__ Y, const float* __restrict__ mod, const float* __restrict__ g, const float* __restrict__ bta, float* __restrict__ xout, const float* __restrict__ modn, bf16* __restrict__ hin) {
    const int row = blockIdx.x * 4 + (threadIdx.x >> 6), lane = threadIdx.x & 63, b = row / S_;
    const float* m = mod + (size_t)b * 6 * D_;
    float v[16]; float s = 0.f;
#pragma unroll
    for (int i = 0; i < 16; ++i) { const int d = lane + 64 * i; float y = 0.f;
#pragma unroll
        for (int k = 0; k < NSLOT; ++k) y += bf2f(Y[((size_t)row * NSLOT + k) * D_ + d]);
        v[i] = ALPHA * x1[(size_t)row * D_ + d] + m[5 * D_ + d] * y; s += v[i]; }
    const float mean = wave_sum(s) * (1.f / D_); float q = 0.f;
#pragma unroll
    for (int i = 0; i < 16; ++i) { v[i] -= mean; q += v[i] * v[i]; }
    const float rstd = rsqrtf(wave_sum(q) * (1.f / D_) + 1e-5f);
#pragma unroll
    for (int i = 0; i < 16; ++i) { const int d = lane + 64 * i; const float o = v[i] * rstd * g[d] + bta[d]; xout[(size_t)row * D_ + d] = o;
        if (modn) { const float* mn = modn + (size_t)b * 6 * D_; hin[(size_t)row * D_ + d] = f2bf(o * (1.f + mn[D_ + d]) + mn[d]); } }
}

__global__ __launch_bounds__(64) void k_route(const float* __restrict__ logit, const float* __restrict__ rbias, unsigned* __restrict__ cnt, int* __restrict__ ltok, float* __restrict__ lw, int* __restrict__ ldst) {
    const int t = blockIdx.x * blockDim.x + threadIdx.x;
    if (t >= T_) return;
    float sc[64], sel[64];
#pragma unroll
    for (int e = 0; e < 64; ++e) { sc[e] = sigmoidf_(logit[(size_t)t * 64 + e]); sel[e] = sc[e] + rbias[e]; }
    float gs[8];
#pragma unroll
    for (int g = 0; g < 8; ++g) { float m1 = -INFINITY, m2 = -INFINITY;
#pragma unroll
        for (int i = 0; i < 8; ++i) { const float v = sel[g * 8 + i]; if (v > m1) { m2 = m1; m1 = v; } else if (v > m2) m2 = v; }
        gs[g] = m1 + m2; }
    unsigned gmask = 0;
#pragma unroll
    for (int k = 0; k < 4; ++k) { int bi = -1; float bv = -INFINITY;
#pragma unroll
        for (int g = 0; g < 8; ++g) if (!((gmask >> g) & 1u) && (bi < 0 || gs[g] > bv)) { bi = g; bv = gs[g]; }
        gmask |= 1u << bi; }
    unsigned long long used = 0ull; int ei[8]; float ew[8]; float wsum = 0.f;
#pragma unroll
    for (int k = 0; k < 8; ++k) { int bi = -1; float bv = -INFINITY;
#pragma unroll
        for (int e = 0; e < 64; ++e) if (((gmask >> (e / 8)) & 1u) && !((used >> e) & 1ull) && (bi < 0 || sel[e] > bv)) { bi = e; bv = sel[e]; }
        used |= 1ull << bi; ei[k] = bi; float w = 0.f;
#pragma unroll
        for (int e = 0; e < 64; ++e) if (e == bi) w = sc[e];
        ew[k] = w; wsum += w; }
    const float inv = 2.5f / wsum;
#pragma unroll
    for (int k = 0; k < 8; ++k) { const int e = ei[k]; const unsigned pos = atomicAdd(&cnt[e], 1u);
        ltok[(size_t)e * T_ + pos] = t; lw[(size_t)e * T_ + pos] = ew[k] * inv; ldst[(size_t)e * T_ + pos] = t * NSLOT + k; }
}
__global__ void k_scan(const unsigned* __restrict__ cnt, unsigned* __restrict__ base) {
    if (threadIdx.x == 0) { unsigned b = 0; for (int e = 0; e < NE; ++e) { base[e] = b; b += (cnt[e] + 255u) / 256u * 256u; } base[NE] = b; base[NE + 1] = b + T_; }
}

extern "C" void kernel_launch(void* const* d_in, const int* in_sizes, int n_in, void* d_out, int out_size, void* d_ws, size_t ws_size, hipStream_t stream) {
    if (n_in != 26 || ws_size < WS_END) { fprintf(stderr, "kernel_launch: bad args n_in %d ws %zu need %zu\n", n_in, ws_size, (size_t)WS_END); return; }
    const float* x = (const float*)d_in[0]; const float* c = (const float*)d_in[1]; const float* w_ada = (const float*)d_in[2]; const float* b_ada = (const float*)d_in[3];
    const float* w_in = (const float*)d_in[4]; const float* q_scale = (const float*)d_in[5]; const float* k_scale = (const float*)d_in[6];
    const float* sgu_g = (const float*)d_in[7]; const float* sgu_b = (const float*)d_in[8]; const float* w_sp = (const float*)d_in[9]; const float* b_sp = (const float*)d_in[10];
    const float* w_a = (const float*)d_in[11]; const float* w_b = (const float*)d_in[12]; const float* w_out = (const float*)d_in[13];
    const float* ln1_g = (const float*)d_in[14]; const float* ln1_b = (const float*)d_in[15]; const float* router_w = (const float*)d_in[16]; const float* router_b = (const float*)d_in[17];
    const float* w_gate = (const float*)d_in[18]; const float* w_up = (const float*)d_in[19]; const float* w_down = (const float*)d_in[20];
    const float* ws_gate = (const float*)d_in[21]; const float* ws_up = (const float*)d_in[22]; const float* ws_down = (const float*)d_in[23];
    const float* ln2_g = (const float*)d_in[24]; const float* ln2_b = (const float*)d_in[25];
    unsigned char* ws = (unsigned char*)d_ws;
    unsigned* ctl = (unsigned*)(ws + WS_CTL);
    float* mod = (float*)(ws + WS_MOD); float* rope = (float*)(ws + WS_ROPE);
    int* ltok = (int*)(ws + WS_LIST); float* lw = (float*)(ws + WS_LIST + 4 * MiB); int* ldst = (int*)(ws + WS_LIST + 8 * MiB);
    float* stats = (float*)(ws + WS_STATS);
    float* X = (float*)(ws + WS_X); float* X1 = (float*)(ws + WS_X1); bf16* HA = (bf16*)(ws + WS_HA); bf16* HB = (bf16*)(ws + WS_HB);
    unsigned char* ov = ws + WS_OV;
    bf16* Qb = (bf16*)(ov + OV_Q); bf16* Kb = (bf16*)(ov + OV_K); bf16* Vb = (bf16*)(ov + OV_V); bf16* U = (bf16*)(ov + OV_U); bf16* VG = (bf16*)(ov + OV_VG);
    bf16* GA = (bf16*)(ov + OV_GA); bf16* GB = (bf16*)(ov + OV_GB); bf16* OA = (bf16*)(ov + OV_OA); bf16* OB = (bf16*)(ov + OV_OB); bf16* YB = (bf16*)(ov + OV_YB);
    float* TMP = (float*)(ov + OV_TMP); float* PQK = (float*)(ov + OV_PQK); float* LOG = (float*)(ov + OV_LOG); bf16* Y = (bf16*)(ov + OV_Y);

    hipMemsetAsync(ws + WS_CTL, 0, CTL_BYTES, stream);
    k_mod<<<(L_ * B_ * 6 * D_ + 255) / 256, 256, 0, stream>>>(c, w_ada, b_ada, mod);
    k_rope<<<(S_ * 32 + 255) / 256, 256, 0, stream>>>(rope);
    for (int l = 0; l < L_; ++l) {
        bf16* W = (bf16*)(ws + WS_W + (size_t)l * WL_BYTES);
        const dim3 tb(32, 8);
        k_transpose<<<dim3(INC / 32, D_ / 32, 1), tb, 0, stream>>>(w_in + (size_t)l * D_ * INC, W + WO_IN, D_, INC, 0, 0, 0);
        k_transpose<<<dim3(D_ / 32, AW / 32, 1), tb, 0, stream>>>(w_a + (size_t)l * AW * D_, W + WO_A, AW, D_, 0, 0, 0);
        k_transpose<<<dim3(D_ / 32, SW / 32, 1), tb, 0, stream>>>(w_b + (size_t)l * SW * D_, W + WO_B, SW, D_, 0, 0, 0);
        k_transpose<<<dim3(D_ / 32, D_ / 32, 1), tb, 0, stream>>>(w_out + (size_t)l * D_ * D_, W + WO_OUT, D_, D_, 0, 0, 0);
        k_transpose<<<dim3(NE / 32, D_ / 32, 1), tb, 0, stream>>>(router_w + (size_t)l * D_ * NE, W + WO_R, D_, NE, 0, 0, 0);
        k_transpose<<<dim3(EFF / 32, D_ / 32, NE), tb, 0, stream>>>(w_gate + (size_t)l * NE * D_ * EFF, W + WO_GU, D_, EFF, 1, (size_t)D_ * EFF, (size_t)512 * D_);
        k_transpose<<<dim3(EFF / 32, D_ / 32, NE), tb, 0, stream>>>(w_up + (size_t)l * NE * D_ * EFF, W + WO_GU, D_, EFF, 2, (size_t)D_ * EFF, (size_t)512 * D_);
        k_transpose<<<dim3(EFF / 32, D_ / 32, 1), tb, 0, stream>>>(ws_gate + (size_t)l * D_ * EFF, W + WO_GU + (size_t)NE * 512 * D_, D_, EFF, 1, 0, 0);
        k_transpose<<<dim3(EFF / 32, D_ / 32, 1), tb, 0, stream>>>(ws_up + (size_t)l * D_ * EFF, W + WO_GU + (size_t)NE * 512 * D_, D_, EFF, 2, 0, 0);
        k_transpose<<<dim3(D_ / 32, EFF / 32, NE), tb, 0, stream>>>(w_down + (size_t)l * NE * EFF * D_, W + WO_DN, EFF, D_, 0, (size_t)EFF * D_, (size_t)D_ * EFF);
        k_transpose<<<dim3(D_ / 32, EFF / 32, 1), tb, 0, stream>>>(ws_down + (size_t)l * EFF * D_, W + WO_DN + (size_t)NE * D_ * EFF, EFF, D_, 0, 0, 0);
        k_cvt<<<(8 * 128 * 128 + 255) / 256, 256, 0, stream>>>(w_sp + (size_t)l * 8 * 128 * 128, W + WO_SP, 8 * 128 * 128);
    }
    k_modulate<<<(unsigned)(((size_t)T_ * D_ + 255) / 256), 256, 0, stream>>>(x, mod, HA);
    for (int l = 0; l < L_; ++l) {
        bf16* W = (bf16*)(ws + WS_W + (size_t)l * WL_BYTES);
        const float* modl = mod + (size_t)l * B_ * 6 * D_;
        const float* xin = (l == 0) ? x : X;
        unsigned* cnt = ctl + CW_CNT + l * 64; unsigned* base = ctl + CW_BASE + l * 128;
        { EpiIn e{HA, W + WO_IN, PQK, Vb, U, VG, GA, GB}; k_gemm<EpiIn, false><<<dim3(INC / 64, T_ / 128, 1), 256, 0, stream>>>(e); }
        k_qknorm<<<(T_ * 10 + 255) / 256, 256, 0, stream>>>(PQK, q_scale + l * 64, k_scale + l * 64, rope, Qb, Kb);
        k_attn<<<dim3(S_ / 256, NQH, B_), 256, 0, stream>>>(Qb, Kb, Vb, OA);
        k_vstats<<<T_ / 4, 256, 0, stream>>>(VG, stats);
        k_sgu<<<T_, 512, 0, stream>>>(U, VG, stats, sgu_g + l * SW, sgu_b + l * SW, w_sp + (size_t)l * 8 * 128 * 128, b_sp + (size_t)l * 8 * 128, OB);
        { EpiBrA e{OA, W + WO_A, GA, TMP}; k_gemm<EpiBrA, false><<<dim3(D_ / 64, T_ / 128, 1), 256, 0, stream>>>(e); }
        { EpiBrB e{OB, W + WO_B, GB, TMP, YB}; k_gemm<EpiBrB, false><<<dim3(D_ / 64, T_ / 128, 1), 256, 0, stream>>>(e); }
        { EpiF32 e{YB, W + WO_OUT, TMP, D_, D_}; k_gemm<EpiF32, false><<<dim3(D_ / 64, T_ / 128, 1), 256, 0, stream>>>(e); }
        k_ln1<<<T_ / 4, 256, 0, stream>>>(xin, TMP, modl, ln1_g + l * D_, ln1_b + l * D_, X1, HA);
        { EpiF32 e{HA, W + WO_R, LOG, D_, NE}; k_gemm<EpiF32, false><<<dim3(NE / 64, T_ / 128, 1), 256, 0, stream>>>(e); }
        k_route<<<T_ / 64, 64, 0, stream>>>(LOG, router_b + l * NE, cnt, ltok, lw, ldst);
        k_scan<<<1, 64, 0, stream>>>(cnt, base);
        { EpiGU e{HA, W + WO_GU, HB, cnt, base, ltok}; k_gemm<EpiGU, true><<<dim3(EFF / 64, T_ / 128, NEX), 256, 0, stream>>>(e); }
        { EpiDN e{HB, W + WO_DN, Y, cnt, base, lw, ldst}; k_gemm<EpiDN, false><<<dim3(D_ / 64, T_ / 128, NEX), 256, 0, stream>>>(e); }
        const bool last = (l == L_ - 1);
        k_ln2<<<T_ / 4, 256, 0, stream>>>(X1, Y, modl, ln2_g + l * D_, ln2_b + l * D_, last ? (float*)d_out : X, last ? nullptr : modl + (size_t)B_ * 6 * D_, HA);
    }
}
```
